# Optimizing an MI355X kernel written in HIP

```python
import jax, jax.numpy as jnp
from jax import lax
import numpy as np

D_MODEL = 1024
BATCH = 8
SEQ = 4096
DEPTH = 4

GRID_W = 64
HEAD_DIM = 64
A_HEADS = 8
A_KV_HEADS = 2
B_HEADS = 8
B_KV_HEADS = 2
C_HEADS = D_MODEL // HEAD_DIM
Q_BLOCK = 128
WINDOW = 128
NA_KH = 8
NA_KW = 16
MEM_TOKENS = 256
MEM_HEADS = 4
MEM_HEAD_DIM = D_MODEL // MEM_HEADS
D_FF = 256 * ((8 * D_MODEL // 3 + 255) // 256)
ROPE_THETA = 10000.0
LN_EPS = 1e-5
RMS_EPS = 1e-6
ALPHA = (2.0 * DEPTH) ** 0.25
BETA = (8.0 * DEPTH) ** -0.25
N_EVEN = (DEPTH + 1) // 2
N_ODD = DEPTH // 2

A_Q = A_HEADS * HEAD_DIM
A_KV = A_KV_HEADS * HEAD_DIM
B_Q = B_HEADS * HEAD_DIM
B_KV = B_KV_HEADS * HEAD_DIM
AB_IN = A_Q + 2 * A_KV + B_Q + 2 * B_KV
AB_OUT = (A_HEADS + B_HEADS) * HEAD_DIM
AB_SPLITS = [A_Q, A_Q + A_KV, A_Q + 2 * A_KV, A_Q + 2 * A_KV + B_Q, A_Q + 2 * A_KV + B_Q + B_KV]
C_WIDTH = C_HEADS * HEAD_DIM

kernel_name = "hybrid_axial_window_neighbourhood_encoder"


def layer_norm(x, g, b):
    xf = x.astype(jnp.float32)
    mu = xf.mean(-1, keepdims=True)
    var = jnp.square(xf - mu).mean(-1, keepdims=True)
    return ((xf - mu) * lax.rsqrt(var + LN_EPS) * g.astype(jnp.float32) + b.astype(jnp.float32)).astype(x.dtype)


def rms_norm(x, g):
    xf = x.astype(jnp.float32)
    return (xf * lax.rsqrt(jnp.mean(xf * xf, -1, keepdims=True) + RMS_EPS) * g.astype(jnp.float32)).astype(x.dtype)


def swiglu(x, w_gate, w_up, w_down):
    return (jax.nn.silu(x @ w_gate) * (x @ w_up)) @ w_down


def rope_angles(pos, dim):
    inv = ROPE_THETA ** (-jnp.arange(0, dim, 2, dtype=jnp.float32) / dim)
    return pos[:, None] * inv[None, :]


def apply_rope(x, ang):
    half = x.shape[-1] // 2
    cos = jnp.cos(ang)[None, :, None, :].astype(x.dtype)
    sin = jnp.sin(ang)[None, :, None, :].astype(x.dtype)
    x1, x2 = x[..., :half], x[..., half:]
    return jnp.concatenate([x1 * cos - x2 * sin, x2 * cos + x1 * sin], axis=-1)


def global_gqa(q, k, v):
    B, S, H, d = q.shape
    Hkv = k.shape[2]
    G = H // Hkv
    nb = S // Q_BLOCK
    scale = d ** -0.5
    qb = q.reshape(B, nb, Q_BLOCK, Hkv, G, d).transpose(1, 0, 2, 3, 4, 5)

    def one_block(q_blk):
        s = jnp.einsum('bqkgd,bskd->bkgqs', q_blk, k).astype(jnp.float32) * scale
        p = jax.nn.softmax(s, axis=-1).astype(v.dtype)
        return jnp.einsum('bkgqs,bskd->bqkgd', p, v)

    o = lax.map(one_block, qb)
    return o.transpose(1, 0, 2, 3, 4, 5).reshape(B, S, H * d)


def window_gqa_sink(q, k, v, sink):
    B, S, H, d = q.shape
    Hkv = k.shape[2]
    G = H // Hkv
    nb = S // Q_BLOCK
    scale = d ** -0.5
    qb = q.reshape(B, nb, Q_BLOCK, Hkv, G, d)
    pad = ((0, 0), (Q_BLOCK, Q_BLOCK), (0, 0), (0, 0))
    kp = jnp.pad(k, pad).reshape(B, nb + 2, Q_BLOCK, Hkv, d)
    vp = jnp.pad(v, pad).reshape(B, nb + 2, Q_BLOCK, Hkv, d)
    k_band = jnp.concatenate([kp[:, :-2], kp[:, 1:-1], kp[:, 2:]], axis=2)
    v_band = jnp.concatenate([vp[:, :-2], vp[:, 1:-1], vp[:, 2:]], axis=2)
    blk = jnp.arange(nb)[:, None] * Q_BLOCK
    qi = blk + jnp.arange(Q_BLOCK)[None, :]
    kj = blk - Q_BLOCK + jnp.arange(3 * Q_BLOCK)[None, :]
    rel = kj[:, None, :] - qi[:, :, None]
    valid = (jnp.abs(rel) <= WINDOW) & (kj[:, None, :] >= 0) & (kj[:, None, :] < S)
    s = jnp.einsum('bnqkgd,bnskd->bnkgqs', qb, k_band).astype(jnp.float32) * scale
    s = jnp.where(valid[None, :, None, None], s, -jnp.inf)
    sink_l = sink.astype(jnp.float32).reshape(Hkv, G)[None, None, :, :, None, None]
    m = jnp.maximum(s.max(-1, keepdims=True), sink_l)
    p = jnp.exp(s - m)
    p = (p / (p.sum(-1, keepdims=True) + jnp.exp(sink_l - m))).astype(v.dtype)
    o = jnp.einsum('bnkgqs,bnskd->bnqkgd', p, v_band)
    return o.reshape(B, S, H * d)


def mixer_ab(h, w_in, w_out, q_gain, k_gain, sink, ang_2d, ang_1d):
    B, S, _ = h.shape
    qa, ka, va, qb, kb, vb = jnp.split(h @ w_in, AB_SPLITS, axis=-1)
    qa = qa.reshape(B, S, A_HEADS, HEAD_DIM)
    ka = ka.reshape(B, S, A_KV_HEADS, HEAD_DIM)
    va = va.reshape(B, S, A_KV_HEADS, HEAD_DIM)
    qa = apply_rope(rms_norm(qa, q_gain), ang_2d)
    ka = apply_rope(rms_norm(ka, k_gain), ang_2d)
    out_a = global_gqa(qa, ka, va)
    qb = apply_rope(qb.reshape(B, S, B_HEADS, HEAD_DIM), ang_1d)
    kb = apply_rope(kb.reshape(B, S, B_KV_HEADS, HEAD_DIM), ang_1d)
    vb = vb.reshape(B, S, B_KV_HEADS, HEAD_DIM)
    out_b = window_gqa_sink(qb, kb, vb, sink)
    return jnp.concatenate([out_a, out_b], axis=-1) @ w_out


def mixer_c(h, w_in, w_out, rpb):
    B, S, _ = h.shape
    rows = S // GRID_W
    kh = min(NA_KH, rows)
    kw = NA_KW
    scale = HEAD_DIM ** -0.5
    q, k, v = jnp.split(h @ w_in, 3, axis=-1)
    qg = q.reshape(B, rows, GRID_W, C_HEADS, HEAD_DIM)
    kg = k.reshape(B, rows, GRID_W, C_HEADS, HEAD_DIM)
    vg = v.reshape(B, rows, GRID_W, C_HEADS, HEAD_DIM)
    col = jnp.arange(GRID_W)
    col_start = jnp.clip(col - kw // 2, 0, GRID_W - kw)
    col_idx = col_start[:, None] + jnp.arange(kw)[None, :]
    dc = col_idx - col[:, None]

    def row_block(r):
        rs = jnp.clip(r - kh // 2, 0, rows - kh)
        k_rows = lax.dynamic_slice_in_dim(kg, rs, kh, axis=1)
        v_rows = lax.dynamic_slice_in_dim(vg, rs, kh, axis=1)
        k_nb = jnp.take(k_rows, col_idx, axis=2)
        v_nb = jnp.take(v_rows, col_idx, axis=2)
        q_r = lax.dynamic_index_in_dim(qg, r, axis=1, keepdims=False)
        dr = rs + jnp.arange(kh) - r
        bias = rpb[:, dr[None, :, None] + NA_KH - 1, dc[:, None, :] + NA_KW - 1]
        s = jnp.einsum('bwhd,bawjhd->bhwaj', q_r, k_nb).astype(jnp.float32) * scale
        s = s + bias.astype(jnp.float32)[None]
        p = jax.nn.softmax(s.reshape(B, C_HEADS, GRID_W, kh * kw), axis=-1)
        p = p.reshape(B, C_HEADS, GRID_W, kh, kw).astype(v.dtype)
        return jnp.einsum('bhwaj,bawjhd->bwhd', p, v_nb)

    o = lax.map(row_block, jnp.arange(rows))
    o = o.transpose(1, 0, 2, 3, 4).reshape(B, S, C_WIDTH)
    return o @ w_out


def memory_attn(h, mem, w_q, w_kv, w_o):
    B, S, _ = h.shape
    M = mem.shape[1]
    q = (h @ w_q).reshape(B, S, MEM_HEADS, MEM_HEAD_DIM)
    k, v = jnp.split(mem @ w_kv, 2, axis=-1)
    k = k.reshape(B, M, MEM_HEADS, MEM_HEAD_DIM)
    v = v.reshape(B, M, MEM_HEADS, MEM_HEAD_DIM)
    s = jnp.einsum('bshd,bmhd->bhsm', q, k).astype(jnp.float32) * (MEM_HEAD_DIM ** -0.5)
    p = jax.nn.softmax(s, axis=-1).astype(v.dtype)
    o = jnp.einsum('bhsm,bmhd->bshd', p, v).reshape(B, S, D_MODEL)
    return o @ w_o


def setup_inputs(seed: int = 0) -> dict:
    key = jax.random.key(seed)
    ks = jax.random.split(key, 20)
    nrm = jax.random.normal
    f32 = jnp.float32
    d_sc = D_MODEL ** -0.5
    return {
        "x": nrm(ks[0], (BATCH, SEQ, D_MODEL), f32),
        "mem": nrm(ks[1], (BATCH, MEM_TOKENS, D_MODEL), f32),
        "ln_g": 1.0 + 0.02 * nrm(ks[2], (DEPTH, 4, D_MODEL), f32),
        "ln_b": 0.02 * nrm(ks[3], (DEPTH, 4, D_MODEL), f32),
        "ffn_w_gate": nrm(ks[4], (DEPTH, 2, D_MODEL, D_FF), f32) * d_sc,
        "ffn_w_up": nrm(ks[5], (DEPTH, 2, D_MODEL, D_FF), f32) * d_sc,
        "ffn_w_down": nrm(ks[6], (DEPTH, 2, D_FF, D_MODEL), f32) * (D_FF ** -0.5) * BETA,
        "ab_w_in": nrm(ks[7], (N_EVEN, D_MODEL, AB_IN), f32) * d_sc,
        "ab_w_out": nrm(ks[8], (N_EVEN, AB_OUT, D_MODEL), f32) * (AB_OUT ** -0.5) * BETA,
        "ab_q_gain": 1.0 + 0.02 * nrm(ks[9], (N_EVEN, HEAD_DIM), f32),
        "ab_k_gain": 1.0 + 0.02 * nrm(ks[10], (N_EVEN, HEAD_DIM), f32),
        "ab_sink": 0.5 * nrm(ks[11], (N_EVEN, B_HEADS), f32),
        "c_w_in": nrm(ks[12], (N_ODD, D_MODEL, 3 * C_WIDTH), f32) * d_sc,
        "c_w_out": nrm(ks[13], (N_ODD, C_WIDTH, D_MODEL), f32) * (C_WIDTH ** -0.5) * BETA,
        "c_rpb": 0.1 * nrm(ks[14], (N_ODD, C_HEADS, 2 * NA_KH - 1, 2 * NA_KW - 1), f32),
        "mem_w_q": nrm(ks[15], (DEPTH, D_MODEL, D_MODEL), f32) * d_sc,
        "mem_w_kv": nrm(ks[16], (DEPTH, D_MODEL, 2 * D_MODEL), f32) * d_sc,
        "mem_w_o": nrm(ks[17], (DEPTH, D_MODEL, D_MODEL), f32) * d_sc * BETA,
    }


def reference(x, mem, ln_g, ln_b, ffn_w_gate, ffn_w_up, ffn_w_down,
              ab_w_in, ab_w_out, ab_q_gain, ab_k_gain, ab_sink,
              c_w_in, c_w_out, c_rpb, mem_w_q, mem_w_kv, mem_w_o):
    S = x.shape[1]
    t = jnp.arange(S)
    row = (t // GRID_W).astype(jnp.float32)
    colp = (t % GRID_W).astype(jnp.float32)
    ang_2d = jnp.concatenate([rope_angles(row, HEAD_DIM // 2), rope_angles(colp, HEAD_DIM // 2)], axis=-1)
    ang_1d = rope_angles(t.astype(jnp.float32), HEAD_DIM)
    for i in range(DEPTH):
        j = i // 2
        y = swiglu(x, ffn_w_gate[i, 0], ffn_w_up[i, 0], ffn_w_down[i, 0])
        x = layer_norm(ALPHA * x + 0.5 * y, ln_g[i, 0], ln_b[i, 0])
        if i % 2 == 0:
            y = mixer_ab(x, ab_w_in[j], ab_w_out[j], ab_q_gain[j], ab_k_gain[j], ab_sink[j], ang_2d, ang_1d)
        else:
            y = mixer_c(x, c_w_in[j], c_w_out[j], c_rpb[j])
        x = layer_norm(ALPHA * x + y, ln_g[i, 1], ln_b[i, 1])
        y = memory_attn(x, mem, mem_w_q[i], mem_w_kv[i], mem_w_o[i])
        x = layer_norm(ALPHA * x + y, ln_g[i, 2], ln_b[i, 2])
        y = swiglu(x, ffn_w_gate[i, 1], ffn_w_up[i, 1], ffn_w_down[i, 1])
        x = layer_norm(ALPHA * x + 0.5 * y, ln_g[i, 3], ln_b[i, 3])
    return x
```

```cpp
#include <hip/hip_runtime.h>
#include <hip/hip_cooperative_groups.h>
#include <hip/hip_bf16.h>
#include <cstdio>
#include <cstdint>
#include <cmath>
namespace cg = cooperative_groups;

#ifndef EN_A0
#define EN_A0 1
#endif
#ifndef EN_A1
#define EN_A1 1
#endif
#ifndef EN_A2
#define EN_A2 1
#endif
#ifndef EN_MEM
#define EN_MEM 1
#endif
#ifndef EN_G1
#define EN_G1 1
#endif
#ifndef EN_G2
#define EN_G2 1
#endif
#ifndef EN_G3
#define EN_G3 1
#endif
#ifndef EN_MISC
#define EN_MISC 1
#endif
#ifndef MK_COOP
#define MK_COOP 0
#endif

namespace pg8 {
#define PG8_LAS __attribute__((address_space(3)))
typedef unsigned short bf16_t;
typedef short bf16x8 __attribute__((ext_vector_type(8)));
typedef float f32x4 __attribute__((ext_vector_type(4)));
typedef unsigned u32x4 __attribute__((ext_vector_type(4)));
constexpr int BM = 256, BK = 64, HALF = 128, HTB = HALF * BK * 2, STAGE_BYTES = 8 * HTB, NXCD = 8, WGM = 8;

__host__ __device__ __forceinline__ int lds_byte(int r, int c) { const int st = (r >> 4) * 2 + (c >> 5), rr = r & 15, cc = c & 31, ob = rr * 64 + cc * 2; return st * 1024 + (ob ^ (((ob >> 9) & 1) << 5)); }
__host__ __device__ __forceinline__ void stage_rc(int b, int& R, int& C) { const int st = b / 1024, sb = b % 1024, swz = sb ^ (((sb >> 9) & 1) << 5); R = (st >> 1) * 16 + swz / 64; C = (st & 1) * 32 + (swz % 64) / 2; }
__host__ __device__ __forceinline__ int perm32(int rho) { const int n = rho >> 4, i = rho & 15; return 8 * (i >> 2) + 4 * n + (i & 3); }

struct Unit { int pm, pn; };
struct Gemm { const bf16_t* A; const bf16_t* Bt; int M, N, K, lda; };

struct StaticOrder {
    int nM, nN, nwg, G, c;
    __host__ __device__ void init(int M, int N, int G_, int c_) { nM = M / BM; nN = N / BM; nwg = nM * nN; G = G_; c = c_; }
    __host__ __device__ bool next(int i, Unit& u) const {
        const long L = (long)i * G + c; if (L >= nwg) return false;
        int wgid = (int)L; { const int q = nwg / NXCD, r = nwg % NXCD, xcd = wgid % NXCD, off = wgid / NXCD; wgid = (xcd < r ? xcd * (q + 1) : r * (q + 1) + (xcd - r) * q) + off; }
        const int nig = WGM * nN, gid = wgid / nig, fm = gid * WGM, gsz = (nM - fm) < WGM ? (nM - fm) : WGM;
        u.pm = fm + ((wgid % nig) % gsz); u.pn = (wgid % nig) / gsz; return true;
    }
};

__device__ __forceinline__ unsigned cvt_pk_bf16(float lo, float hi) { unsigned r; asm volatile("v_cvt_pk_bf16_f32 %0, %1, %2" : "=v"(r) : "v"(lo), "v"(hi)); return r; }

struct EpiBf16S {
    static constexpr bool PERM = true;
    bf16_t* O; int ldc; int scale_cols; float sc;
    __device__ __forceinline__ void operator()(const f32x4 (&acc)[2][2][4][2], const Unit& u, int wr, int wc, int fr, int fq) const {
        const int row0 = u.pm * BM + wr * 64 + fr; const int colt = u.pn * BM; const float s = (colt < scale_cols) ? sc : 1.f;
        const int col0 = colt + wc * 32 + 8 * fq;
#pragma unroll
        for (int ai = 0; ai < 2; ++ai)
#pragma unroll
            for (int m = 0; m < 4; ++m) { bf16_t* rowp = O + (size_t)(row0 + ai * HALF + m * 16) * ldc + col0;
#pragma unroll
                for (int bj = 0; bj < 2; ++bj) { f32x4 v0 = acc[ai][bj][m][0] * s, v1 = acc[ai][bj][m][1] * s;
                    u32x4 w; w.x = cvt_pk_bf16(v0[0], v0[1]); w.y = cvt_pk_bf16(v0[2], v0[3]); w.z = cvt_pk_bf16(v1[0], v1[1]); w.w = cvt_pk_bf16(v1[2], v1[3]);
                    *(u32x4*)(rowp + bj * HALF) = w; } }
    }
};
__device__ __forceinline__ float silu_mul(float g, float u) { return g * u * __builtin_amdgcn_rcpf(1.0f + __builtin_amdgcn_exp2f(-1.4426950408889634f * g)); }
struct EpiSwiGLU {
    static constexpr bool PERM = true;
    bf16_t* H; int ldh;
    __device__ __forceinline__ void operator()(const f32x4 (&acc)[2][2][4][2], const Unit& u, int wr, int wc, int fr, int fq) const {
        const int row0 = u.pm * BM + wr * 64 + fr; const int col0 = u.pn * HALF + wc * 32 + 8 * fq;
#pragma unroll
        for (int ai = 0; ai < 2; ++ai)
#pragma unroll
            for (int m = 0; m < 4; ++m) { bf16_t* rowp = H + (size_t)(row0 + ai * HALF + m * 16) * ldh + col0;
                const f32x4 g0 = acc[ai][0][m][0], g1 = acc[ai][0][m][1], u0 = acc[ai][1][m][0], u1 = acc[ai][1][m][1];
                u32x4 w; w.x = cvt_pk_bf16(silu_mul(g0[0], u0[0]), silu_mul(g0[1], u0[1])); w.y = cvt_pk_bf16(silu_mul(g0[2], u0[2]), silu_mul(g0[3], u0[3]));
                w.z = cvt_pk_bf16(silu_mul(g1[0], u1[0]), silu_mul(g1[1], u1[1])); w.w = cvt_pk_bf16(silu_mul(g1[2], u1[2]), silu_mul(g1[3], u1[3]));
                *(u32x4*)rowp = w; }
    }
};
struct EpiResid {
    static constexpr bool PERM = false;
    const float* src; float* dst; float alpha, s;
    __device__ __forceinline__ void operator()(const f32x4 (&acc)[2][2][4][2], const Unit& u, int wr, int wc, int fr, int fq) const {
        const int row0 = u.pm * BM + wr * 64 + fr, col0 = u.pn * BM + wc * 32 + 4 * fq;
#pragma unroll
        for (int ai = 0; ai < 2; ++ai)
#pragma unroll
            for (int m = 0; m < 4; ++m) { const size_t off = (size_t)(row0 + ai * HALF + m * 16) * 1024 + col0;
#pragma unroll
                for (int bj = 0; bj < 2; ++bj)
#pragma unroll
                    for (int n = 0; n < 2; ++n) { const f32x4 x = *(const f32x4*)(src + off + bj * HALF + n * 16); *(f32x4*)(dst + off + bj * HALF + n * 16) = x * alpha + acc[ai][bj][m][n] * s; } }
    }
};

template <class Epi>
__device__ __forceinline__ void gemm_phase(PG8_LAS unsigned char* lds, const Gemm g, const StaticOrder& S, const Epi& E, const int tid) {
    const int wid = __builtin_amdgcn_readfirstlane(tid >> 6), lane = tid & 63, wr = wid >> 2, wc = wid & 3, fr = lane & 15, fq = lane >> 4;
    const int K = g.K, nt = K / BK, lda = g.lda;
    unsigned voffA[2], voffB[2];
#pragma unroll
    for (int i = 0; i < 2; ++i) { int R, C; stage_rc(tid * 16 + i * 8192, R, C); const int Rb = Epi::PERM ? ((R & ~31) + perm32(R & 31)) : R;
        voffA[i] = (unsigned)(R * lda + C) * 2u; voffB[i] = (unsigned)(Rb * K + C) * 2u; }
    const size_t kstep = (size_t)(BK * 2);
    const size_t hstepA = (size_t)HALF * lda * 2, hstepB = (size_t)HALF * K * 2;
    const size_t tstepA = 2 * hstepA, tstepB = 2 * hstepB;
    const unsigned ldsw = (unsigned)wid * 1024u;
    const int aoff = lds_byte(wr * 64 + fr, fq * 8), boff = lds_byte(wc * 32 + fr, fq * 8);
#define PG8_SA(b, h) (((b) * 2 + (h)) * HTB)
#define PG8_SB(b, h) ((4 + (b) * 2 + (h)) * HTB)
#define PG8_STAGE(bufoff, gbase, voff) do { _Pragma("unroll") for (int _i = 0; _i < 2; ++_i) \
        __builtin_amdgcn_global_load_lds((const unsigned*)((const char*)(gbase) + (voff)[_i]), (PG8_LAS unsigned*)(lds + (bufoff) + ldsw + _i * 8192), 16, 0, 0); } while (0)
#define PG8_LDA(dst, b, h) do { _Pragma("unroll") for (int m = 0; m < 4; ++m) _Pragma("unroll") for (int k = 0; k < 2; ++k) dst[m][k] = *(const PG8_LAS bf16x8*)(lds + PG8_SA(b, h) + aoff + m * 2048 + k * 1024); } while (0)
#define PG8_LDB(dst, b, h) do { _Pragma("unroll") for (int n = 0; n < 2; ++n) _Pragma("unroll") for (int k = 0; k < 2; ++k) dst[n][k] = *(const PG8_LAS bf16x8*)(lds + PG8_SB(b, h) + boff + n * 2048 + k * 1024); } while (0)
#define PG8_MMA(ai, bj, At, Bt) do { __builtin_amdgcn_s_setprio(1); _Pragma("unroll") for (int m = 0; m < 4; ++m) _Pragma("unroll") for (int n = 0; n < 2; ++n) _Pragma("unroll") for (int k = 0; k < 2; ++k) \
        acc[ai][bj][m][n] = __builtin_amdgcn_mfma_f32_16x16x32_bf16(Bt[n][k], At[m][k], acc[ai][bj][m][n], 0, 0, 0); __builtin_amdgcn_s_setprio(0); } while (0)
#define PG8_WAIT_V(n) asm volatile("s_waitcnt vmcnt(" #n ")" ::: "memory")
#define PG8_WAIT_L(n) asm volatile("s_waitcnt lgkmcnt(" #n ")" ::: "memory")
#define PG8_BAR __builtin_amdgcn_s_barrier()
#define PG8_SCHED __builtin_amdgcn_sched_barrier(0)
    Unit cur, nxt; int ui = 0;
    if (!S.next(0, cur)) return;
    f32x4 acc[2][2][4][2];
#pragma unroll
    for (int a = 0; a < 2; ++a)
#pragma unroll
        for (int b = 0; b < 2; ++b)
#pragma unroll
            for (int m = 0; m < 4; ++m)
#pragma unroll
                for (int n = 0; n < 2; ++n) acc[a][b][m][n] = (f32x4){0.f, 0.f, 0.f, 0.f};
    bf16x8 At[4][2], B0[2][2], B1[2][2];
    const char* cA = (const char*)g.A + (size_t)cur.pm * tstepA; const char* cB = (const char*)g.Bt + (size_t)cur.pn * tstepB;
    PG8_STAGE(PG8_SB(0, 0), cB, voffB); PG8_STAGE(PG8_SB(0, 1), cB + hstepB, voffB); PG8_STAGE(PG8_SA(0, 0), cA, voffA); PG8_STAGE(PG8_SA(0, 1), cA + hstepA, voffA);
    if (wr == 1) PG8_BAR;
    PG8_WAIT_V(2); PG8_BAR;
    PG8_STAGE(PG8_SB(1, 0), cB + kstep, voffB); PG8_STAGE(PG8_SA(1, 0), cA + kstep, voffA); PG8_STAGE(PG8_SB(1, 1), cB + hstepB + kstep, voffB);
    PG8_WAIT_V(6); PG8_BAR;
    for (;;) {
        const bool has_next = S.next(ui + 1, nxt);
        const char* nA = has_next ? (const char*)g.A + (size_t)nxt.pm * tstepA : cA; const char* nB = has_next ? (const char*)g.Bt + (size_t)nxt.pn * tstepB : cB;
        for (int t = 0; t < nt; t += 2) {
            const bool last = (t == nt - 2);
            const char* a1 = cA + (size_t)(t + 1) * kstep;
            const char* a2 = last ? nA : cA + (size_t)(t + 2) * kstep; const char* b2 = last ? nB : cB + (size_t)(t + 2) * kstep;
            const char* a3 = a2 + kstep; const char* b3 = b2 + kstep;
            PG8_LDB(B0, 0, 0); PG8_LDB(B1, 0, 1); PG8_SCHED; PG8_LDA(At, 0, 0); PG8_STAGE(PG8_SA(1, 1), a1 + hstepA, voffA);
            PG8_WAIT_V(8); PG8_WAIT_L(0); PG8_BAR; PG8_MMA(0, 0, At, B0); PG8_MMA(0, 1, At, B1); PG8_BAR; PG8_SCHED;
            PG8_LDA(At, 0, 1); PG8_STAGE(PG8_SB(0, 0), b2, voffB); PG8_STAGE(PG8_SB(0, 1), b2 + hstepB, voffB); PG8_STAGE(PG8_SA(0, 0), a2, voffA);
            PG8_WAIT_V(8); PG8_WAIT_L(0); PG8_BAR; PG8_MMA(1, 0, At, B0); PG8_MMA(1, 1, At, B1); PG8_BAR; PG8_SCHED;
            PG8_LDB(B0, 1, 0); PG8_LDB(B1, 1, 1); PG8_SCHED; PG8_LDA(At, 1, 0); PG8_STAGE(PG8_SA(0, 1), a2 + hstepA, voffA);
            PG8_WAIT_V(8); PG8_WAIT_L(0); PG8_BAR; PG8_MMA(0, 0, At, B0); PG8_MMA(0, 1, At, B1); PG8_BAR; PG8_SCHED;
            PG8_LDA(At, 1, 1); PG8_STAGE(PG8_SB(1, 0), b3, voffB); PG8_STAGE(PG8_SB(1, 1), b3 + hstepB, voffB); PG8_STAGE(PG8_SA(1, 0), a3, voffA);
            PG8_WAIT_V(8); PG8_WAIT_L(0); PG8_BAR; PG8_MMA(1, 0, At, B0); PG8_MMA(1, 1, At, B1); PG8_BAR; PG8_SCHED;
        }
        if (wr == 0) PG8_BAR;
        E(acc, cur, wr, wc, fr, fq);
        if (!has_next) break;
#pragma unroll
        for (int a = 0; a < 2; ++a)
#pragma unroll
            for (int b = 0; b < 2; ++b)
#pragma unroll
                for (int m = 0; m < 4; ++m)
#pragma unroll
                    for (int n = 0; n < 2; ++n) acc[a][b][m][n] = (f32x4){0.f, 0.f, 0.f, 0.f};
        cur = nxt; cA = nA; cB = nB; ++ui;
        if (wr == 1) PG8_BAR;
    }
    PG8_WAIT_V(0);
    PG8_BAR;
#undef PG8_SA
#undef PG8_SB
#undef PG8_STAGE
#undef PG8_LDA
#undef PG8_LDB
#undef PG8_MMA
#undef PG8_WAIT_V
#undef PG8_WAIT_L
#undef PG8_BAR
#undef PG8_SCHED
}
}

namespace attn_body {
using bf16=__hip_bfloat16;
using bf16x8=__attribute__((ext_vector_type(8)))short;
using s16x4=__attribute__((ext_vector_type(4)))short;
using f32x16=__attribute__((ext_vector_type(16)))float;
using u32x4=__attribute__((ext_vector_type(4)))unsigned;
constexpr int D=64;
constexpr int NW=8,QBLK=32,QB=QBLK*NW,KVBLK=64;
__device__ __forceinline__ int crow(int r,int hi){return (r&3)+8*(r>>2)+4*hi;}
#define SBAR() __builtin_amdgcn_sched_barrier(0)
typedef __attribute__((address_space(3))) const float* lds_cfptr;
template<int MODE> __device__ __forceinline__ void amask(f32x16&p0,f32x16&p1,int ta,int qabs,int hi,int qgr,lds_cfptr tab){
  const float NEG=-INFINITY;
  if(MODE==1){
    const int dlt=64*ta+4*hi-qabs+128;
    #pragma unroll
    for(int r=0;r<16;++r){const int c=(r&3)+8*(r>>2); if((unsigned)(dlt+c)>256u)p0[r]=NEG; if((unsigned)(dlt+c+32)>256u)p1[r]=NEG;}
  } else if(MODE==2){
    int rs=qgr-4; rs=rs<0?0:rs; rs=rs>56?56:rs;
    if(ta<rs||ta>=rs+8){
      #pragma unroll
      for(int r=0;r<16;++r){p0[r]=NEG;p1[r]=NEG;}
    } else {
      const int qcol=qabs&63; int cs=qcol-8; cs=cs<0?0:cs; cs=cs>48?48:cs;
      const int base=(ta-qgr+7)*31+15-qcol+4*hi, kc0=4*hi-cs;
      #pragma unroll
      for(int r=0;r<16;++r){const int c=(r&3)+8*(r>>2);
        const float b0=tab[base+c], b1=tab[base+c+32];
        p0[r]=((unsigned)(kc0+c)<16u)?(p0[r]+b0):NEG;
        p1[r]=((unsigned)(kc0+c+32)<16u)?(p1[r]+b1):NEG;}
    }
  }
}

constexpr int NSLOT=3, SLOTB=8192;
constexpr int LDS_K=0, LDS_V=NSLOT*SLOTB, LDS_WS=2*NSLOT*SLOTB, LDS_OST=LDS_WS+NW*64*4, LDS_BYTES=LDS_OST+NW*4096;
constexpr int LDS_TAB=LDS_BYTES;
constexpr float C2=0.125f*1.4426950408889634f;
__device__ __forceinline__ void glds16(const void*gsrc,unsigned lds_dst){unsigned keep;
  asm volatile("s_mov_b32 %0, m0\n\ts_mov_b32 m0, %2\n\ts_nop 0\n\tglobal_load_lds_dwordx4 %1, off\n\ts_mov_b32 m0, %0":"=&s"(keep):"v"(gsrc),"s"(lds_dst):"memory");}
__device__ __forceinline__ float max3f(float a,float b,float c){float r;asm("v_max3_f32 %0, %1, %2, %3":"=v"(r):"v"(a),"v"(b),"v"(c));return r;}
__device__ __forceinline__ float max2f(float a,float b){float r;asm("v_max_f32_e32 %0, %1, %2":"=v"(r):"v"(a),"v"(b));return r;}
__device__ __forceinline__ float fadd_s(float a,float b){float r;asm("v_add_f32_e32 %0, %1, %2":"=v"(r):"v"(a),"v"(b));return r;}
__device__ __forceinline__ float fsub_s(float a,float b){float r;asm("v_sub_f32_e32 %0, %1, %2":"=v"(r):"v"(a),"v"(b));return r;}
typedef float f32x2_t __attribute__((ext_vector_type(2))); typedef __bf16 bf16x2_t __attribute__((ext_vector_type(2)));
__device__ __forceinline__ unsigned cvtpk_s(float lo,float hi){f32x2_t v={lo,hi};bf16x2_t b=__builtin_convertvector(v,bf16x2_t);return __builtin_bit_cast(unsigned,b);}
#define WAIT_BAR(N) asm volatile("s_waitcnt vmcnt(" #N ") lgkmcnt(0)\n\ts_barrier":::"memory")

__device__ __forceinline__ void qkt(f32x16&p0,f32x16&p1,const char*Kslot,const bf16x8*qr,const f32x16&negm,int r32,int hi){
  const char*kb=Kslot+hi*1024+r32*16;
  #pragma unroll
  for(int d0=0;d0<4;++d0){
    const bf16x8 b0=*reinterpret_cast<const bf16x8*>(kb+d0*2048);
    const bf16x8 b1=*reinterpret_cast<const bf16x8*>(kb+d0*2048+512);
    if(d0==0){p0=__builtin_amdgcn_mfma_f32_32x32x16_bf16(b0,qr[0],negm,0,0,0);p1=__builtin_amdgcn_mfma_f32_32x32x16_bf16(b1,qr[0],negm,0,0,0);}
    else{p0=__builtin_amdgcn_mfma_f32_32x32x16_bf16(b0,qr[d0],p0,0,0,0);p1=__builtin_amdgcn_mfma_f32_32x32x16_bf16(b1,qr[d0],p1,0,0,0);}}
}
typedef __attribute__((address_space(3))) const char* lds_cptr;
typedef short v4i16_t __attribute__((ext_vector_type(4)));
__device__ __forceinline__ void kload8(bf16x8*kf,lds_cptr kp){
  kf[0]=*(const __attribute__((address_space(3))) bf16x8*)(kp);      kf[1]=*(const __attribute__((address_space(3))) bf16x8*)(kp+512);
  kf[2]=*(const __attribute__((address_space(3))) bf16x8*)(kp+2048); kf[3]=*(const __attribute__((address_space(3))) bf16x8*)(kp+2560);
  kf[4]=*(const __attribute__((address_space(3))) bf16x8*)(kp+4096); kf[5]=*(const __attribute__((address_space(3))) bf16x8*)(kp+4608);
  kf[6]=*(const __attribute__((address_space(3))) bf16x8*)(kp+6144); kf[7]=*(const __attribute__((address_space(3))) bf16x8*)(kp+6656);
}
__device__ __forceinline__ void kload2(bf16x8*kf,lds_cptr kp,int j){ kf[2*j]=*(const __attribute__((address_space(3))) bf16x8*)(kp+j*2048); kf[2*j+1]=*(const __attribute__((address_space(3))) bf16x8*)(kp+j*2048+512); }
__device__ __forceinline__ s16x4 vtr(lds_cptr p){ return __builtin_bit_cast(s16x4,__builtin_amdgcn_ds_read_tr16_b64_v4i16((__attribute__((address_space(3))) v4i16_t*)p)); }
__device__ __forceinline__ float rowmax(const f32x16&p0,const f32x16&p1){
  float a=max3f(p0[0],p0[1],p1[0]),b=max3f(p0[2],p0[3],p1[1]);a=max3f(a,p1[2],p1[3]);
  #pragma unroll
  for(int r=4;r<16;r+=4){a=max3f(a,p0[r],p0[r+1]);b=max3f(b,p0[r+2],p0[r+3]);a=max3f(a,p1[r],p1[r+1]);b=max3f(b,p1[r+2],p1[r+3]);}
  const float m=max2f(a,b);
  auto rr=__builtin_amdgcn_permlane32_swap(__float_as_uint(m),__float_as_uint(m),false,false);
  return max2f(__uint_as_float(rr[0]),__uint_as_float(rr[1]));
}
__device__ __forceinline__ void pv(f32x16*o,int vb,bf16x8 pa0,bf16x8 pa1,bf16x8 pa2,bf16x8 pa3){
  #pragma unroll
  for(int d0=0;d0<2;++d0){s16x4 lo[4],hi[4];
    #pragma unroll
    for(int ks=0;ks<4;++ks){
      asm volatile("ds_read_b64_tr_b16 %0,%1 offset:%c2":"=&v"(lo[ks]):"v"(vb),"i"(d0*4096+ks*1024):"memory");
      asm volatile("ds_read_b64_tr_b16 %0,%1 offset:%c2":"=&v"(hi[ks]):"v"(vb),"i"(d0*4096+ks*1024+512):"memory");}
    asm volatile("s_waitcnt lgkmcnt(0)":::"memory");SBAR();
    #define PK(k) (bf16x8){lo[k][0],lo[k][1],lo[k][2],lo[k][3],hi[k][0],hi[k][1],hi[k][2],hi[k][3]}
    o[d0]=__builtin_amdgcn_mfma_f32_32x32x16_bf16(pa0,PK(0),o[d0],0,0,0);
    o[d0]=__builtin_amdgcn_mfma_f32_32x32x16_bf16(pa1,PK(1),o[d0],0,0,0);
    o[d0]=__builtin_amdgcn_mfma_f32_32x32x16_bf16(pa2,PK(2),o[d0],0,0,0);
    o[d0]=__builtin_amdgcn_mfma_f32_32x32x16_bf16(pa3,PK(3),o[d0],0,0,0);
    #undef PK
  }
}

template<int MODE,int THRL> __device__ __forceinline__ void attn_unit(long rowq,long rowk0,int q0,int t0,int NT,const bf16*Qc,const bf16*__restrict__ Kc,const bf16*__restrict__ Vc,bf16*Oc,int DM,char*shm,float sinkL,const int tid){
  const int lane=tid&63,r32=lane&31,hi=lane>>5; const int wid=__builtin_amdgcn_readfirstlane(tid>>6);
  const bf16*Qw=Qc+(rowq+wid*QBLK)*DM;
  const bf16*Kh=Kc+(rowk0+(long)t0*KVBLK)*DM,*Vh=Vc+(rowk0+(long)t0*KVBLK)*DM;
  const unsigned lds0=(unsigned)(uintptr_t)shm;
  float*wsf=(float*)(shm+LDS_WS)+wid*64;
  const bf16*ksrc=Kh+(long)lane*DM+wid*8;
  const bf16*vsrc=Vh+(long)(16*(wid&3)+(lane>>2))*DM+(wid>>2)*32+(lane&3)*8;
  const unsigned kdst=lds0+LDS_K+wid*1024, vdst=lds0+LDS_V+wid*1024;
  #define DMA_K(t,slot) glds16(ksrc+(long)(t)*KVBLK*DM,(unsigned)__builtin_amdgcn_readfirstlane(kdst+(slot)))
  #define DMA_V(t,slot) glds16(vsrc+(long)(t)*KVBLK*DM,(unsigned)__builtin_amdgcn_readfirstlane(vdst+(slot)))
  const int vb0=(int)(lds0+LDS_V)+((lane>>4)&1)*32+(lane&3)*8+(4*hi+((lane&15)>>2))*64;
  const char*Kbase=shm+LDS_K; bf16x8 kf[8];
  const lds_cptr shm3=(lds_cptr)shm; const lds_cptr kp0=shm3+LDS_K+hi*1024+r32*16; const lds_cptr vp0=shm3+LDS_V+((lane>>4)&1)*32+(lane&3)*8+(4*hi+((lane&15)>>2))*64;
  const lds_cfptr tab=(lds_cfptr)(shm3+LDS_TAB);
  DMA_K(0,0);DMA_V(0,0);DMA_K(1,SLOTB);
  bf16x8 qr[4];
  #pragma unroll
  for(int d0=0;d0<4;++d0)qr[d0]=*reinterpret_cast<const bf16x8*>(&Qw[(long)r32*DM+d0*16+hi*8]);
  constexpr bool NEGM=(MODE==0);
  float mhat=0.f,l_reg=0.f;f32x16 o[2];o[0]=f32x16{};o[1]=f32x16{};float zf_=0.f;asm volatile("":"+v"(zf_));f32x16 negm;_Pragma("unroll") for(int r=0;r<16;++r)negm[r]=zf_;if(NEGM)asm volatile("":"+v"(negm));
  const int qabs=q0+wid*QBLK+r32; const int qgr=(q0+wid*QBLK)>>6;
  #define CMASK(P0,P1,t) do{ if(MODE!=0) amask<MODE>(P0,P1,t0+(t),qabs,hi,qgr,tab); }while(0)
  bool resc=false;
  #define START(P0,P1) do{ const float rm=rowmax(P0,P1); resc=false; \
    { const float dl=(rm>-1e30f)?rm:0.f; mhat=fadd_s(mhat,dl); \
      _Pragma("unroll") for(int r=0;r<16;++r){P0[r]=fsub_s(P0[r],dl);P1[r]=fsub_s(P1[r],dl);} \
      if(NEGM){ _Pragma("unroll") for(int r=0;r<16;++r)negm[r]=-mhat; asm volatile("":"+v"(negm)); } } \
    _Pragma("unroll") for(int r=0;r<16;++r)P0[r]=__builtin_amdgcn_exp2f(P0[r]); }while(0)
  #define RESC() do{ if(resc){ asm volatile("s_waitcnt lgkmcnt(0)":::"memory"); \
      _Pragma("unroll") for(int d_=0;d_<2;++d_) _Pragma("unroll") for(int r=0;r<16;++r)o[d_][r]*=wsf[crow(r,hi)]; } }while(0)
  f32x16 pA0,pA1,pB0,pB1;
  int sl_prev=0,sl_cur=0,sl_next=SLOTB;
  #define ROT() do{sl_prev=sl_cur;sl_cur=sl_next;sl_next=(sl_next==(NSLOT-1)*SLOTB)?0:sl_next+SLOTB;}while(0)
  DMA_K(2,2*SLOTB);
  WAIT_BAR(3);
  qkt(pA0,pA1,Kbase,qr,negm,r32,hi);asm volatile("s_nop 15\n\ts_nop 7":"+v"(pA0),"+v"(pA1));CMASK(pA0,pA1,0);
  START(pA0,pA1);
  _Pragma("unroll") for(int r=0;r<16;++r)pA1[r]=__builtin_amdgcn_exp2f(pA1[r]);
  WAIT_BAR(0);
  DMA_K(3,0);DMA_V(1,SLOTB);
  ROT();
  kload8(kf,kp0+sl_cur);
  WAIT_BAR(2);
  s16x4 vlo[8],vhi[8]; u32x4 pw0,pw1,pw2,pw3;
  #define PKW(P,B) cvtpk_s(P[B],P[B+1])
  #define PAF(k) __builtin_bit_cast(bf16x8,pw##k)
  #define VFR(i) (bf16x8){vlo[i][0],vlo[i][1],vlo[i][2],vlo[i][3],vhi[i][0],vhi[i][1],vhi[i][2],vhi[i][3]}
  #define PIN(x) asm volatile("":"+v"(x))
  #define MX3(a,b,c) __builtin_fmaxf(__builtin_fmaxf((a),(b)),(c))
  #define GAPA(MF,A0,A1,A2,A3,W0,W1,PW) do{ MF; sacc+=A0; sacc+=A1; sacc+=A2; sacc+=A3; PIN(sacc); W0; W1; PIN(PW); SBAR(); }while(0)
  #define EX(v) __builtin_amdgcn_exp2f(v)
  #define GAPB(MF,X,B) do{ MF; X[B]=EX(X[B]); X[B+1]=EX(X[B+1]); X[B+2]=EX(X[B+2]); X[B+3]=EX(X[B+3]); PIN(X); SBAR(); }while(0)
  #define VRD(i) do{ vlo[i]=vtr(vp_+(((i)>>2)*4096+((i)&3)*1024)); vhi[i]=vtr(vp_+(((i)>>2)*4096+((i)&3)*1024+512)); }while(0)
  #define KRD(G,j) do{ if(G){ kload2(kf,kp0+sl_next,j); SBAR(); } }while(0)
  #define STEP(C0,C1,P0,P1,t,GK,GV,GL) do{ SBAR(); \
    const lds_cptr vp_=vp0+sl_prev; \
    VRD(0); SBAR(); float sacc=(P0[0]+P0[1]); \
    GAPA(C0=__builtin_amdgcn_mfma_f32_32x32x16_bf16(kf[0],qr[0],negm,0,0,0), P0[2],P0[3],P0[4],P0[5],     pw0[0]=PKW(P0,0), pw0[1]=PKW(P0,2), pw0); \
    VRD(4); SBAR(); GAPA(C1=__builtin_amdgcn_mfma_f32_32x32x16_bf16(kf[1],qr[0],negm,0,0,0), P0[6],P0[7],P0[8],P0[9],     pw0[2]=PKW(P0,4), pw0[3]=PKW(P0,6), pw0); \
    VRD(1); SBAR(); GAPA(C0=__builtin_amdgcn_mfma_f32_32x32x16_bf16(kf[2],qr[1],C0,0,0,0),   P0[10],P0[11],P0[12],P0[13], pw1[0]=PKW(P0,8), pw1[1]=PKW(P0,10), pw1); \
    VRD(5); SBAR(); GAPA(C1=__builtin_amdgcn_mfma_f32_32x32x16_bf16(kf[3],qr[1],C1,0,0,0),   P0[14],P0[15],P1[0],P1[1],   pw1[2]=PKW(P0,12),pw1[3]=PKW(P0,14), pw1); \
    VRD(2); SBAR(); GAPA(C0=__builtin_amdgcn_mfma_f32_32x32x16_bf16(kf[4],qr[2],C0,0,0,0),   P1[2],P1[3],P1[4],P1[5],     pw2[0]=PKW(P1,0), pw2[1]=PKW(P1,2), pw2); \
    VRD(6); SBAR(); GAPA(C1=__builtin_amdgcn_mfma_f32_32x32x16_bf16(kf[5],qr[2],C1,0,0,0),   P1[6],P1[7],P1[8],P1[9],     pw2[2]=PKW(P1,4), pw2[3]=PKW(P1,6), pw2); \
    VRD(3); SBAR(); GAPA(C0=__builtin_amdgcn_mfma_f32_32x32x16_bf16(kf[6],qr[3],C0,0,0,0),   P1[10],P1[11],P1[12],P1[13], pw3[0]=PKW(P1,8), pw3[1]=PKW(P1,10), pw3); \
    VRD(7); SBAR(); GAPA(C1=__builtin_amdgcn_mfma_f32_32x32x16_bf16(kf[7],qr[3],C1,0,0,0),   P1[14],P1[15],0.f,0.f,       pw3[2]=PKW(P1,12),pw3[3]=PKW(P1,14), pw3); \
    l_reg+=sacc; \
    if(GK){DMA_K((t)+3,sl_cur);} if(GV){DMA_V((t)+1,sl_next);} \
    if(!NEGM){ _Pragma("unroll") for(int r=0;r<16;++r){C0[r]-=mhat;C1[r]-=mhat;} } \
    CMASK(C0,C1,t); \
    { float a=MX3(C0[0],C0[1],C1[0]),b=MX3(C0[2],C0[3],C1[1]); a=MX3(a,C1[2],C1[3]); \
      _Pragma("unroll") for(int r=4;r<16;r+=4){a=MX3(a,C0[r],C0[r+1]);b=MX3(b,C0[r+2],C0[r+3]);a=MX3(a,C1[r],C1[r+1]);b=MX3(b,C1[r+2],C1[r+3]);} \
      float rm=__builtin_fmaxf(a,b); { auto rr=__builtin_amdgcn_permlane32_swap(__float_as_uint(rm),__float_as_uint(rm),false,false); rm=__builtin_fmaxf(__uint_as_float(rr[0]),__uint_as_float(rr[1])); } \
      resc=false; \
      if(__builtin_expect(__any(rm>(float)THRL),0)){ const float dl=__builtin_fmaxf(rm,0.f); mhat+=dl; \
        _Pragma("unroll") for(int r=0;r<16;++r){C0[r]-=dl;C1[r]-=dl;} \
        if(NEGM){ _Pragma("unroll") for(int r=0;r<16;++r)negm[r]=-mhat; asm volatile("":"+v"(negm)); } \
        const float f=__builtin_amdgcn_exp2f(-dl); l_reg*=f; if(hi==0)wsf[r32]=f; resc=true; } } \
    SBAR(); \
    GAPB(o[0]=__builtin_amdgcn_mfma_f32_32x32x16_bf16(PAF(0),VFR(0),o[0],0,0,0), C0,0); \
    GAPB(o[1]=__builtin_amdgcn_mfma_f32_32x32x16_bf16(PAF(0),VFR(4),o[1],0,0,0), C0,4); \
    KRD(GL,0); GAPB(o[0]=__builtin_amdgcn_mfma_f32_32x32x16_bf16(PAF(1),VFR(1),o[0],0,0,0), C0,8); \
    KRD(GL,1); GAPB(o[1]=__builtin_amdgcn_mfma_f32_32x32x16_bf16(PAF(1),VFR(5),o[1],0,0,0), C0,12); \
    KRD(GL,2); GAPB(o[0]=__builtin_amdgcn_mfma_f32_32x32x16_bf16(PAF(2),VFR(2),o[0],0,0,0), C1,0); \
    KRD(GL,3); GAPB(o[1]=__builtin_amdgcn_mfma_f32_32x32x16_bf16(PAF(2),VFR(6),o[1],0,0,0), C1,4); \
    GAPB(o[0]=__builtin_amdgcn_mfma_f32_32x32x16_bf16(PAF(3),VFR(3),o[0],0,0,0), C1,8); \
    GAPB(o[1]=__builtin_amdgcn_mfma_f32_32x32x16_bf16(PAF(3),VFR(7),o[1],0,0,0), C1,12); \
    }while(0)
  int t=1;
  for(;t+5<NT;t+=2){
    STEP(pB0,pB1,pA0,pA1,t,true,true,true);     WAIT_BAR(2); RESC(); ROT();
    STEP(pA0,pA1,pB0,pB1,t+1,true,true,true);   WAIT_BAR(2); RESC(); ROT();
  }
  #define ENDW(tt) do{ if((tt)+3<NT){WAIT_BAR(2);} else if((tt)+2<NT){WAIT_BAR(1);} else {WAIT_BAR(0);} }while(0)
  for(;t+1<NT;t+=2){
    STEP(pB0,pB1,pA0,pA1,t,(t+3<NT),(t+1<NT),(t+1<NT));       ENDW(t);   RESC(); ROT();
    STEP(pA0,pA1,pB0,pB1,t+1,(t+4<NT),(t+2<NT),(t+2<NT));     ENDW(t+1); RESC(); ROT();
  }
  STEP(pB0,pB1,pA0,pA1,NT-1,false,false,false); RESC();
  { float sacc=pB0[0]+pB0[1]; _Pragma("unroll") for(int r=2;r<16;++r)sacc+=pB0[r]; _Pragma("unroll") for(int r=0;r<16;++r)sacc+=pB1[r]; l_reg+=sacc;
    pw0=(u32x4){PKW(pB0,0),PKW(pB0,2),PKW(pB0,4),PKW(pB0,6)};pw1=(u32x4){PKW(pB0,8),PKW(pB0,10),PKW(pB0,12),PKW(pB0,14)};pw2=(u32x4){PKW(pB1,0),PKW(pB1,2),PKW(pB1,4),PKW(pB1,6)};pw3=(u32x4){PKW(pB1,8),PKW(pB1,10),PKW(pB1,12),PKW(pB1,14)};
    SBAR(); pv(o,vb0+sl_cur,PAF(0),PAF(1),PAF(2),PAF(3)); }
  #undef PKW
  #undef PAF
  #undef VFR
  #undef PIN
  #undef MX3
  #undef GAPA
  #undef GAPB
  #undef EX
  #undef VRD
  #undef KRD
  #undef STEP
  #undef ENDW
  {auto rr=__builtin_amdgcn_permlane32_swap(__float_as_uint(l_reg),__float_as_uint(l_reg),false,false);l_reg=__uint_as_float(rr[0])+__uint_as_float(rr[1]);}
  if(MODE==1) l_reg+=__builtin_amdgcn_exp2f(sinkL-mhat);
  if(hi==0)wsf[32+r32]=l_reg;asm volatile("s_waitcnt lgkmcnt(0)":::"memory");
  float rli[16];
  #pragma unroll
  for(int r=0;r<16;++r)rli[r]=__builtin_amdgcn_rcpf(wsf[32+crow(r,hi)]);
  bf16*Ow=Oc+(rowq+wid*QBLK)*DM;
  { bf16*stg=(bf16*)(shm+LDS_OST)+wid*2048;
    #pragma unroll
    for(int r=0;r<16;++r){const int orow=crow(r,hi);
      #pragma unroll
      for(int d0=0;d0<2;++d0)stg[orow*64+d0*32+r32]=__float2bfloat16(o[d0][r]*rli[r]);}
    asm volatile("s_waitcnt lgkmcnt(0)":::"memory");
    #pragma unroll
    for(int i=0;i<4;++i){const int row=i*8+(lane>>3),ch=lane&7; const u32x4 v=*(const u32x4*)(stg+row*64+ch*8); *(u32x4*)(Ow+(long)row*DM+ch*8)=v;} }
  asm volatile("s_waitcnt lgkmcnt(0)\n\ts_barrier":::"memory");
  #undef DMA_K
  #undef DMA_V
  #undef CMASK
  #undef START
  #undef RESC
  #undef ROT
}
#undef SBAR
#undef WAIT_BAR
}

typedef unsigned short bf16_t;
typedef float f32x4 __attribute__((ext_vector_type(4)));
typedef short bf16x8 __attribute__((ext_vector_type(8)));
typedef unsigned v4u __attribute__((ext_vector_type(4)));
typedef unsigned v2u __attribute__((ext_vector_type(2)));
#define LAS __attribute__((address_space(3)))
#define LDS_WAIT() asm volatile("s_waitcnt lgkmcnt(0)" ::: "memory")

constexpr int BATCH = 8, SEQ = 4096, DM = 1024, MTOK = BATCH * SEQ, FF = 2816, DEPTH = 4, MEMT = 256;
constexpr float LOG2E = 1.4426950408889634f;
constexpr float ALPHA = 1.6817928305074290f;
constexpr int NWAVES = 8;
constexpr int LDS_BYTES = 147456;
constexpr int N_PHASES = 2 + 15 * DEPTH;

constexpr size_t MiB = 1u << 20;
constexpr size_t WS_ROPE = 1 * MiB;
constexpr size_t WS_MEMB = 3 * MiB;
constexpr size_t WS_MEMK = 8 * MiB;
constexpr size_t WS_VT = 24 * MiB;
constexpr size_t WS_WT = 40 * MiB;
constexpr size_t WS_XB = 240 * MiB;
constexpr size_t WS_BIG = 304 * MiB;
constexpr size_t WS_END = 496 * MiB;
constexpr size_t E_GU = 0;
constexpr size_t E_DN = E_GU + (size_t)8 * 5632 * 1024;
constexpr size_t E_MQ = E_DN + (size_t)8 * 1024 * 2816;
constexpr size_t E_MO = E_MQ + (size_t)4 * 1024 * 1024;
constexpr size_t E_MK = E_MO + (size_t)4 * 1024 * 1024;
constexpr size_t E_MV = E_MK + (size_t)4 * 1024 * 1024;
constexpr size_t E_ABIN = E_MV + (size_t)4 * 1024 * 1024;
constexpr size_t E_ABOUT = E_ABIN + (size_t)2 * 1536 * 1024;
constexpr size_t E_CIN = E_ABOUT + (size_t)2 * 1024 * 1024;
constexpr size_t E_COUT = E_CIN + (size_t)2 * 3072 * 1024;
constexpr size_t E_END = E_COUT + (size_t)2 * 1024 * 1024;
static_assert(WS_WT + E_END * 2 <= WS_XB, "weights fit");
static_assert(WS_BIG + (size_t)MTOK * 3072 * 2 <= WS_END, "big fits");

__device__ const float INV2D[16] = {1.f,0.562341332f,0.316227764f,0.177827939f,0.100000001f,0.0562341325f,0.0316227749f,0.0177827943f,0.00999999978f,0.00562341325f,0.00316227763f,0.00177827943f,0.00100000005f,0.000562341302f,0.000316227757f,0.00017782794f};
__device__ const float INV1D[32] = {1.f,0.749894261f,0.562341332f,0.421696514f,0.316227764f,0.237137377f,0.177827939f,0.133352131f,0.100000001f,0.0749894157f,0.0562341325f,0.0421696529f,0.0316227749f,0.0237137377f,0.0177827943f,0.0133352149f,0.00999999978f,0.00749894185f,0.00562341325f,0.00421696482f,0.00316227763f,0.00237137359f,0.00177827943f,0.00133352145f,0.00100000005f,0.000749894243f,0.000562341302f,0.000421696517f,0.000316227757f,0.00023713737f,0.00017782794f,0.00013335215f};

struct Args {
    const float *x, *mem, *ln_g, *ln_b, *w_gate, *w_up, *w_down, *ab_w_in, *ab_w_out, *ab_q_gain, *ab_k_gain, *ab_sink, *c_w_in, *c_w_out, *c_rpb, *mem_w_q, *mem_w_kv, *mem_w_o;
    float* out; unsigned char* ws; int ph_lo, ph_hi;
};

__device__ __forceinline__ unsigned f2bf(float f) { unsigned u = __builtin_bit_cast(unsigned, f); return (u + 0x7fffu + ((u >> 16) & 1u)) >> 16; }
__device__ __forceinline__ unsigned pk2(float lo, float hi) { return f2bf(lo) | (f2bf(hi) << 16); }
__device__ __forceinline__ float bf2f(unsigned short b) { return __builtin_bit_cast(float, ((unsigned)b) << 16); }
__device__ __forceinline__ float shx(float v, int mask, int lane) { return __builtin_bit_cast(float, __builtin_amdgcn_ds_bpermute((lane ^ mask) << 2, __builtin_bit_cast(int, v))); }
__device__ __forceinline__ float wave_sum(float v, int lane) {
#pragma unroll
    for (int o = 1; o < 64; o <<= 1) v += shx(v, o, lane);
    return v;
}

struct Job { const float* W; bf16_t* WT; int K, ldn, col0, ncols, row0, blk, bstride; };
__device__ __forceinline__ void transpose_item(const Job& J, LAS float* scr, int item, int lane) {
    const int nblk = J.ncols / 32, kb = item / nblk, nb = item % nblk, k0 = 64 * kb, c0 = 32 * nb;
    const float* W = J.W + J.col0 + c0;
#pragma unroll 8
    for (int i = 0; i < 32; ++i) { const int kk = 2 * i + (lane >> 5); scr[kk * 33 + (lane & 31)] = W[(size_t)(k0 + kk) * J.ldn + (lane & 31)]; }
    LDS_WAIT(); asm volatile("" ::: "memory");
    const int c = lane & 7;
    const int rbase = J.row0 + (c0 / J.blk) * J.bstride + (c0 % J.blk);
#pragma unroll
    for (int j = 0; j < 4; ++j) { const int n = (lane >> 3) + 8 * j; const LAS float* s = scr + (8 * c) * 33 + n;
        v4u o; o.x = pk2(s[0 * 33], s[1 * 33]); o.y = pk2(s[2 * 33], s[3 * 33]); o.z = pk2(s[4 * 33], s[5 * 33]); o.w = pk2(s[6 * 33], s[7 * 33]);
        *(v4u*)(J.WT + (size_t)(rbase + n) * J.K + k0 + 8 * c) = o; }
    LDS_WAIT(); asm volatile("" ::: "memory");
}
constexpr int NJOBS = 24 + 16 + 14 + 4;
__device__ __forceinline__ Job get_job(const Args& a, bf16_t* WT, int j) {
    Job J; J.blk = 1 << 20; J.bstride = 0; J.row0 = 0; J.col0 = 0;
    if (j < 24) { const int lj = j / 3, w = j % 3;
        if (w == 0) { J.W = a.w_gate + (size_t)lj * 1024 * FF; J.WT = WT + E_GU + (size_t)lj * 5632 * 1024; J.K = 1024; J.ldn = FF; J.ncols = FF; J.blk = 128; J.bstride = 256; J.row0 = 0; }
        else if (w == 1) { J.W = a.w_up + (size_t)lj * 1024 * FF; J.WT = WT + E_GU + (size_t)lj * 5632 * 1024; J.K = 1024; J.ldn = FF; J.ncols = FF; J.blk = 128; J.bstride = 256; J.row0 = 128; }
        else { J.W = a.w_down + (size_t)lj * FF * 1024; J.WT = WT + E_DN + (size_t)lj * 1024 * FF; J.K = FF; J.ldn = 1024; J.ncols = 1024; }
        return J; }
    j -= 24;
    if (j < 16) { const int l = j / 4, w = j % 4; J.K = 1024;
        if (w == 0) { J.W = a.mem_w_q + (size_t)l * 1024 * 1024; J.WT = WT + E_MQ + (size_t)l * 1024 * 1024; J.ldn = 1024; J.ncols = 1024; }
        else if (w == 1) { J.W = a.mem_w_kv + (size_t)l * 1024 * 2048; J.WT = WT + E_MK + (size_t)l * 1024 * 1024; J.ldn = 2048; J.ncols = 1024; }
        else if (w == 2) { J.W = a.mem_w_kv + (size_t)l * 1024 * 2048; J.WT = WT + E_MV + (size_t)l * 1024 * 1024; J.ldn = 2048; J.ncols = 1024; J.col0 = 1024; }
        else { J.W = a.mem_w_o + (size_t)l * 1024 * 1024; J.WT = WT + E_MO + (size_t)l * 1024 * 1024; J.ldn = 1024; J.ncols = 1024; }
        return J; }
    j -= 16;
    if (j < 14) { const int jj = j / 7, w = j % 7; J.K = 1024;
        if (w == 6) { J.W = a.ab_w_out + (size_t)jj * 1024 * 1024; J.WT = WT + E_ABOUT + (size_t)jj * 1024 * 1024; J.ldn = 1024; J.ncols = 1024; return J; }
        J.W = a.ab_w_in + (size_t)jj * 1024 * 1536; J.WT = WT + E_ABIN + (size_t)jj * 1536 * 1024; J.ldn = 1536;
        if (w == 0) { J.col0 = 0; J.ncols = 512; J.row0 = 0; }
        else if (w == 1) { J.col0 = 512; J.ncols = 128; J.row0 = 1024; }
        else if (w == 2) { J.col0 = 640; J.ncols = 128; J.row0 = 1152; }
        else if (w == 3) { J.col0 = 768; J.ncols = 512; J.row0 = 512; }
        else if (w == 4) { J.col0 = 1280; J.ncols = 128; J.row0 = 1280; }
        else { J.col0 = 1408; J.ncols = 128; J.row0 = 1408; }
        return J; }
    j -= 14;
    { const int jj = j / 2, w = j % 2; J.K = 1024;
        if (w == 0) { J.W = a.c_w_in + (size_t)jj * 1024 * 3072; J.WT = WT + E_CIN + (size_t)jj * 3072 * 1024; J.ldn = 3072; J.ncols = 3072; }
        else { J.W = a.c_w_out + (size_t)jj * 1024 * 1024; J.WT = WT + E_COUT + (size_t)jj * 1024 * 1024; J.ldn = 1024; J.ncols = 1024; }
        return J; }
}

__device__ __forceinline__ void sincos_d(double a, float& s_out, float& c_out) {
    const double k = __builtin_rint(a * 0.63661977236758134308);
    const double r = (a - k * 1.57079632679489655800) - k * 6.123233995736766036e-17;
    const int q = ((int)(long long)k) & 3;
    const double r2 = r * r;
    const double s = r * (1.0 - r2 / 6.0 * (1.0 - r2 / 20.0 * (1.0 - r2 / 42.0 * (1.0 - r2 / 72.0 * (1.0 - r2 / 110.0 * (1.0 - r2 / 156.0 * (1.0 - r2 / 210.0)))))));
    const double c = 1.0 - r2 / 2.0 * (1.0 - r2 / 12.0 * (1.0 - r2 / 30.0 * (1.0 - r2 / 56.0 * (1.0 - r2 / 90.0 * (1.0 - r2 / 132.0 * (1.0 - r2 / 182.0 * (1.0 - r2 / 240.0)))))));
    double so, co;
    if (q == 0) { so = s; co = c; } else if (q == 1) { so = c; co = -s; } else if (q == 2) { so = -s; co = -c; } else { so = -c; co = s; }
    s_out = (float)so; c_out = (float)co;
}

__device__ __forceinline__ void prologue_phase(const Args& a, LAS unsigned char* lds, int vcu, int G, int wave, int lane) {
    unsigned char* ws = a.ws; bf16_t* WT = (bf16_t*)(ws + WS_WT);
    const int gw = vcu * NWAVES + wave, NGW = G * NWAVES;
    LAS float* scr = (LAS float*)(lds + wave * 16384);
    int off = 0;
    for (int j = 0; j < NJOBS; ++j) {
        const Job J = get_job(a, WT, j);
        const int nitems = (J.K / 64) * (J.ncols / 32);
        int first = gw - off; if (first < 0) first += NGW;
        for (int it = first; it < nitems; it += NGW) transpose_item(J, scr, it, lane);
        off = (off + nitems) % NGW;
    }
    const size_t gt = (size_t)gw * 64 + lane, NGT = (size_t)NGW * 64;
    { const f32x4* src = (const f32x4*)a.x; v4u* dst = (v4u*)(ws + WS_XB);
      for (size_t i = gt; i < (size_t)MTOK * DM / 8; i += NGT) { const f32x4 p = src[2 * i], q = src[2 * i + 1]; v4u o; o.x = pk2(p[0], p[1]); o.y = pk2(p[2], p[3]); o.z = pk2(q[0], q[1]); o.w = pk2(q[2], q[3]); dst[i] = o; } }
    { const f32x4* src = (const f32x4*)a.mem; v4u* dst = (v4u*)(ws + WS_MEMB);
      for (size_t i = gt; i < (size_t)BATCH * MEMT * DM / 8; i += NGT) { const f32x4 p = src[2 * i], q = src[2 * i + 1]; v4u o; o.x = pk2(p[0], p[1]); o.y = pk2(p[2], p[3]); o.z = pk2(q[0], q[1]); o.w = pk2(q[2], q[3]); dst[i] = o; } }
    { float* T = (float*)(ws + WS_ROPE);
      for (size_t i = gt; i < (size_t)SEQ * 32; i += NGT) { const int t = (int)(i >> 5), k = (int)(i & 31);
          const float pos2 = (k < 16) ? (float)(t >> 6) : (float)(t & 63); const float a2 = pos2 * INV2D[k & 15]; const float a1 = (float)t * INV1D[k];
          float s, c; sincos_d((double)a2, s, c); T[i] = c; T[SEQ * 32 + i] = s;
          sincos_d((double)a1, s, c); T[2 * SEQ * 32 + i] = c; T[3 * SEQ * 32 + i] = s; } }
}

__device__ __forceinline__ void ln_phase(float* X, bf16_t* XB, const float* g, const float* b, int gw, int NGW, int lane) {
    const f32x4* g4 = (const f32x4*)g + lane; const f32x4* b4 = (const f32x4*)b + lane;
    for (int m = gw; m < MTOK; m += NGW) {
        f32x4* xr = (f32x4*)(X + (size_t)m * DM) + lane;
        f32x4 v[4]; float s = 0.f;
#pragma unroll
        for (int j = 0; j < 4; ++j) { v[j] = xr[64 * j]; s += (v[j][0] + v[j][1]) + (v[j][2] + v[j][3]); }
        const float mean = wave_sum(s, lane) * (1.f / DM); float s2 = 0.f;
#pragma unroll
        for (int j = 0; j < 4; ++j) { v[j] = v[j] - mean; s2 += (v[j][0] * v[j][0] + v[j][1] * v[j][1]) + (v[j][2] * v[j][2] + v[j][3] * v[j][3]); }
        const float rstd = 1.f / sqrtf(wave_sum(s2, lane) * (1.f / DM) + 1e-5f);
        v2u* o8 = (v2u*)(XB + (size_t)m * DM) + lane;
#pragma unroll
        for (int j = 0; j < 4; ++j) { const f32x4 y = v[j] * rstd * g4[64 * j] + b4[64 * j]; xr[64 * j] = y; v2u w; w.x = pk2(y[0], y[1]); w.y = pk2(y[2], y[3]); o8[64 * j] = w; }
    }
}

__device__ __forceinline__ void prep_phase(bf16_t* QKV, const float* T, const float* qg, const float* kg, int gw, int NGW, int lane) {
    const float gq = qg[lane], gk = kg[lane]; const int i = lane & 31;
    for (int m = gw; m < MTOK; m += NGW) {
        const int t = m & (SEQ - 1);
        const float c2 = T[t * 32 + i], s2 = T[SEQ * 32 + t * 32 + i], c1 = T[2 * SEQ * 32 + t * 32 + i], s1 = T[3 * SEQ * 32 + t * 32 + i];
        bf16_t* row = QKV + (size_t)m * 1536 + lane;
#pragma unroll 4
        for (int hh = 0; hh < 20; ++hh) {
            const int col = (hh < 16) ? hh * 64 : ((hh < 18) ? 1024 + (hh - 16) * 64 : 1280 + (hh - 18) * 64);
            const bool isA = (hh < 8) || (hh == 16) || (hh == 17); const bool isq = hh < 16;
            float v = bf2f(row[col]);
            if (isA) { const float ss = wave_sum(v * v, lane); v = v * (1.0f / sqrtf(ss * (1.f / 64.f) + 1e-6f)) * (isq ? gq : gk); }
            const float pr = shx(v, 32, lane);
            const float c = isA ? c2 : c1, s = isA ? s2 : s1;
            float o = (lane < 32) ? (v * c - pr * s) : (v * c + pr * s);
            if (isq) o *= attn_body::C2;
            row[col] = (bf16_t)f2bf(o);
        }
    }
}

__device__ __forceinline__ void memattn_phase(LAS unsigned char* L, bf16_t* Qm, const bf16_t* MK, const bf16_t* VT, int layer, int vcu, int G, const int tid) {
    const int lane = tid & 63, wid = __builtin_amdgcn_readfirstlane(tid >> 6), c16 = lane & 15, g = lane >> 4;
    constexpr int NU = BATCH * 4 * 32; const int per = (NU + G - 1) / G; int u1 = (vcu + 1) * per; if (u1 > NU) u1 = NU;
    for (int u = vcu * per; u < u1; ++u) {
        const int b = u >> 7, h = (u >> 5) & 3, qblk = u & 31;
        { const bf16_t* kg = MK + (size_t)(b * 256) * 4096 + layer * 1024 + h * 256;
#pragma unroll 4
          for (int i = 0; i < 16; ++i) { const int c = tid + 512 * i, row = c >> 5, ck = c & 31; const v4u v = *(const v4u*)(kg + (size_t)row * 4096 + ck * 8); *(LAS v4u*)(L + row * 528 + ck * 16) = v; } }
        bf16_t* qg = Qm + (size_t)(b * SEQ + qblk * 128 + wid * 16 + c16) * 1024 + h * 256;
        bf16x8 qf[8];
#pragma unroll
        for (int kk = 0; kk < 8; ++kk) qf[kk] = *(const bf16x8*)(qg + kk * 32 + g * 8);
        __syncthreads();
        f32x4 sacc[16];
#pragma unroll
        for (int n = 0; n < 16; ++n) { sacc[n] = (f32x4){0.f, 0.f, 0.f, 0.f};
#pragma unroll
            for (int kk = 0; kk < 8; ++kk) { const bf16x8 a = *(const LAS bf16x8*)(L + (16 * n + c16) * 528 + (32 * kk + 8 * g) * 2); sacc[n] = __builtin_amdgcn_mfma_f32_16x16x32_bf16(a, qf[kk], sacc[n], 0, 0, 0); } }
        float mx = -INFINITY;
#pragma unroll
        for (int n = 0; n < 16; ++n) mx = fmaxf(fmaxf(fmaxf(sacc[n][0], sacc[n][1]), fmaxf(sacc[n][2], sacc[n][3])), mx);
        mx = fmaxf(mx, shx(mx, 16, lane)); mx = fmaxf(mx, shx(mx, 32, lane));
        float l = 0.f;
#pragma unroll
        for (int n = 0; n < 16; ++n)
#pragma unroll
            for (int r = 0; r < 4; ++r) { const float p = __builtin_amdgcn_exp2f(sacc[n][r] - mx); sacc[n][r] = p; l += p; }
        l += shx(l, 16, lane); l += shx(l, 32, lane);
        v4u pf[8];
#pragma unroll
        for (int s = 0; s < 8; ++s) { pf[s].x = pk2(sacc[2 * s][0], sacc[2 * s][1]); pf[s].y = pk2(sacc[2 * s][2], sacc[2 * s][3]); pf[s].z = pk2(sacc[2 * s + 1][0], sacc[2 * s + 1][1]); pf[s].w = pk2(sacc[2 * s + 1][2], sacc[2 * s + 1][3]); }
        __syncthreads();
        { const bf16_t* vg = VT + (size_t)(layer * 1024 + h * 256) * 2048 + b * 256;
#pragma unroll 4
          for (int i = 0; i < 16; ++i) { const int c = tid + 512 * i, row = c >> 5, ck = c & 31; const v4u v = *(const v4u*)(vg + (size_t)row * 2048 + ck * 8); *(LAS v4u*)(L + row * 528 + ck * 16) = v; } }
        __syncthreads();
        const float rl = 1.0f / l;
#pragma unroll
        for (int db = 0; db < 16; ++db) { f32x4 oacc = (f32x4){0.f, 0.f, 0.f, 0.f};
#pragma unroll
            for (int s = 0; s < 8; ++s) { const v2u lo = *(const LAS v2u*)(L + (16 * db + c16) * 528 + (32 * s + 4 * g) * 2), hi = *(const LAS v2u*)(L + (16 * db + c16) * 528 + (32 * s + 16 + 4 * g) * 2);
                const v4u av = (v4u){lo.x, lo.y, hi.x, hi.y};
                oacc = __builtin_amdgcn_mfma_f32_16x16x32_bf16(__builtin_bit_cast(bf16x8, av), __builtin_bit_cast(bf16x8, pf[s]), oacc, 0, 0, 0); }
            v2u w; w.x = pk2(oacc[0] * rl, oacc[1] * rl); w.y = pk2(oacc[2] * rl, oacc[3] * rl);
            *(v2u*)(qg + 16 * db + 4 * g) = w; }
        __syncthreads();
    }
}

template<int MODE, int NB>
__device__ __forceinline__ void winattn_unit(LAS unsigned char* L, bf16_t* QO, const bf16_t* Kg, const bf16_t* Vg, int pitch, long rowb, int q0, int kstart, float sinkL, const LAS float* tab, const int tid) {
    constexpr int NK = NB * 16, KST = 144, VST = (NK + 12) * 2;
    const int lane = tid & 63, wid = __builtin_amdgcn_readfirstlane(tid >> 6), c16 = lane & 15, g = lane >> 4;
    for (int c = tid; c < NK * 8; c += NWAVES * 64) { const int row = c >> 3, ck = c & 7, ka = kstart + row; v4u v = (v4u){0u, 0u, 0u, 0u};
        if ((unsigned)ka < (unsigned)SEQ) v = *(const v4u*)(Kg + (size_t)(rowb + ka) * pitch + ck * 8);
        *(LAS v4u*)(L + row * KST + ck * 16) = v; }
    bf16_t* qg = QO + (size_t)(rowb + q0 + wid * 16 + c16) * pitch;
    bf16x8 qf[2];
#pragma unroll
    for (int kk = 0; kk < 2; ++kk) qf[kk] = *(const bf16x8*)(qg + kk * 32 + g * 8);
    __syncthreads();
    f32x4 sacc[NB];
#pragma unroll
    for (int n = 0; n < NB; ++n) { sacc[n] = (f32x4){0.f, 0.f, 0.f, 0.f};
#pragma unroll
        for (int kk = 0; kk < 2; ++kk) { const bf16x8 a = *(const LAS bf16x8*)(L + (16 * n + c16) * KST + (32 * kk + 8 * g) * 2); sacc[n] = __builtin_amdgcn_mfma_f32_16x16x32_bf16(a, qf[kk], sacc[n], 0, 0, 0); } }
    const int qabs = q0 + wid * 16 + c16;
    if (MODE == 1) {
#pragma unroll
        for (int n = 0; n < NB; ++n)
#pragma unroll
            for (int r = 0; r < 4; ++r) { const int ka = kstart + 16 * n + 4 * g + r; const int d = ka - qabs;
                const bool ok = ((unsigned)ka < (unsigned)SEQ) && (d >= -128) && (d <= 128); sacc[n][r] = ok ? sacc[n][r] : -INFINITY; }
    } else {
        const int qrow = qabs >> 6, qcol = qabs & 63; int rs = qrow - 4; rs = rs < 0 ? 0 : rs; rs = rs > 56 ? 56 : rs; int cs = qcol - 8; cs = cs < 0 ? 0 : cs; cs = cs > 48 ? 48 : cs;
#pragma unroll
        for (int n = 0; n < NB; ++n)
#pragma unroll
            for (int r = 0; r < 4; ++r) { const int ka = kstart + 16 * n + 4 * g + r; const int krow = ka >> 6, kcol = ka & 63;
                const bool ok = (krow >= rs) && (krow < rs + 8) && (kcol >= cs) && (kcol < cs + 16);
                int ti = (krow - qrow + 7) * 31 + (kcol - qcol + 15); ti = ok ? ti : 0;
                const float bv = tab[ti]; sacc[n][r] = ok ? (sacc[n][r] + bv) : -INFINITY; }
    }
    float mx = -INFINITY;
#pragma unroll
    for (int n = 0; n < NB; ++n) mx = fmaxf(fmaxf(fmaxf(sacc[n][0], sacc[n][1]), fmaxf(sacc[n][2], sacc[n][3])), mx);
    mx = fmaxf(mx, shx(mx, 16, lane)); mx = fmaxf(mx, shx(mx, 32, lane));
    float l = 0.f;
#pragma unroll
    for (int n = 0; n < NB; ++n)
#pragma unroll
        for (int r = 0; r < 4; ++r) { const float p = __builtin_amdgcn_exp2f(sacc[n][r] - mx); sacc[n][r] = p; l += p; }
    l += shx(l, 16, lane); l += shx(l, 32, lane);
    if (MODE == 1) l += __builtin_amdgcn_exp2f(sinkL - mx);
    v4u pf[NB / 2];
#pragma unroll
    for (int s = 0; s < NB / 2; ++s) { pf[s].x = pk2(sacc[2 * s][0], sacc[2 * s][1]); pf[s].y = pk2(sacc[2 * s][2], sacc[2 * s][3]); pf[s].z = pk2(sacc[2 * s + 1][0], sacc[2 * s + 1][1]); pf[s].w = pk2(sacc[2 * s + 1][2], sacc[2 * s + 1][3]); }
    __syncthreads();
#pragma unroll 1
    for (int ck = 0; ck < 8; ++ck)
        for (int row = tid; row < NK; row += NWAVES * 64) { const int ka = kstart + row; v4u v = (v4u){0u, 0u, 0u, 0u};
            if ((unsigned)ka < (unsigned)SEQ) v = *(const v4u*)(Vg + (size_t)(rowb + ka) * pitch + ck * 8);
            LAS unsigned short* d = (LAS unsigned short*)(L + (ck * 8) * VST + row * 2);
            d[0] = (unsigned short)(v.x & 0xffff); d[VST / 2] = (unsigned short)(v.x >> 16); d[2 * (VST / 2)] = (unsigned short)(v.y & 0xffff); d[3 * (VST / 2)] = (unsigned short)(v.y >> 16);
            d[4 * (VST / 2)] = (unsigned short)(v.z & 0xffff); d[5 * (VST / 2)] = (unsigned short)(v.z >> 16); d[6 * (VST / 2)] = (unsigned short)(v.w & 0xffff); d[7 * (VST / 2)] = (unsigned short)(v.w >> 16); }
    __syncthreads();
    const float rl = 1.0f / l;
#pragma unroll
    for (int db = 0; db < 4; ++db) { f32x4 oacc = (f32x4){0.f, 0.f, 0.f, 0.f};
#pragma unroll
        for (int s = 0; s < NB / 2; ++s) { const v2u lo = *(const LAS v2u*)(L + (16 * db + c16) * VST + (32 * s + 4 * g) * 2), hi = *(const LAS v2u*)(L + (16 * db + c16) * VST + (32 * s + 16 + 4 * g) * 2);
            const v4u av = (v4u){lo.x, lo.y, hi.x, hi.y};
            oacc = __builtin_amdgcn_mfma_f32_16x16x32_bf16(__builtin_bit_cast(bf16x8, av), __builtin_bit_cast(bf16x8, pf[s]), oacc, 0, 0, 0); }
        v2u w; w.x = pk2(oacc[0] * rl, oacc[1] * rl); w.y = pk2(oacc[2] * rl, oacc[3] * rl);
        *(v2u*)(qg + 16 * db + 4 * g) = w; }
    __syncthreads();
}

__global__ void __launch_bounds__(NWAVES * 64, 2) enc_fwd(Args args) {
    extern __shared__ __attribute__((aligned(16))) unsigned char lds[];
    LAS unsigned char* L = (LAS unsigned char*)lds;
    using attn_body::bf16;

    for (int ph = args.ph_lo; ph < args.ph_hi; ++ph) {
        int zs = 0; asm volatile("" : "+s"(zs));
        const int G = gridDim.x + zs, bx = blockIdx.x + zs; const int vcu = (G % 8 == 0) ? (bx % 8) * (G / 8) + bx / 8 : bx; const int NGW = G * NWAVES;
        int tid = threadIdx.x; asm volatile("" : "+v"(tid));
        const int lane = tid & 63, wave = __builtin_amdgcn_readfirstlane(tid >> 6), gw = vcu * NWAVES + wave;
        unsigned char* ws = args.ws;
        bf16_t* WT = (bf16_t*)(ws + WS_WT); bf16_t* XB = (bf16_t*)(ws + WS_XB); bf16_t* BIG = (bf16_t*)(ws + WS_BIG);
        bf16_t* MEMB = (bf16_t*)(ws + WS_MEMB); bf16_t* MEMK = (bf16_t*)(ws + WS_MEMK); bf16_t* VTB = (bf16_t*)(ws + WS_VT);
        const float* ROPE = (const float*)(ws + WS_ROPE);
        float* X = args.out;
        int gt = 0; pg8::Gemm g{nullptr, nullptr, 0, 0, 0, 0}; bf16_t* gO = nullptr; int gldc = 0, gscols = 0; float gsc = 1.f, gres = 1.f; const float* gsrc = X;
        int l = 0, st = -1, jj = 0; bool even = true;
        if (ph >= 2) { l = (ph - 2) / 15; st = (ph - 2) % 15; jj = l >> 1; even = (l & 1) == 0; }
        if (ph == 1) { gt = 1; g = pg8::Gemm{MEMB, WT + E_MK, BATCH * MEMT, 4096, 1024, 1024}; gO = MEMK; gldc = 4096; }
        else if (st == 0 || st == 12) { const int f = (st == 0) ? 0 : 1; gt = 2; g = pg8::Gemm{XB, WT + E_GU + (size_t)(l * 2 + f) * 5632 * 1024, MTOK, 5632, 1024, 1024}; }
        else if (st == 1 || st == 13) { const int f = (st == 1) ? 0 : 1; gt = 3; g = pg8::Gemm{BIG, WT + E_DN + (size_t)(l * 2 + f) * 1024 * FF, MTOK, 1024, FF, FF}; gres = 0.5f; if (l == 0 && st == 1) gsrc = args.x; }
        else if (st == 3) { gt = 1; gO = BIG;
            if (even) { g = pg8::Gemm{XB, WT + E_ABIN + (size_t)jj * 1536 * 1024, MTOK, 1536, 1024, 1024}; gldc = 1536; }
            else { g = pg8::Gemm{XB, WT + E_CIN + (size_t)jj * 3072 * 1024, MTOK, 3072, 1024, 1024}; gldc = 3072; gscols = 1024; gsc = attn_body::C2; } }
        else if (st == 6) { gt = 3; g = pg8::Gemm{BIG, even ? WT + E_ABOUT + (size_t)jj * 1024 * 1024 : WT + E_COUT + (size_t)jj * 1024 * 1024, MTOK, 1024, 1024, even ? 1536 : 3072}; }
        else if (st == 8) { gt = 1; g = pg8::Gemm{XB, WT + E_MQ + (size_t)l * 1024 * 1024, MTOK, 1024, 1024, 1024}; gO = BIG; gldc = 1024; gscols = 1024; gsc = 0.0625f * LOG2E; }
        else if (st == 10) { gt = 3; g = pg8::Gemm{BIG, WT + E_MO + (size_t)l * 1024 * 1024, MTOK, 1024, 1024, 1024}; }

        if (gt != 0) {
            pg8::StaticOrder S; S.init(g.M, g.N, G, bx);
            if (gt == 1) {
                const int nrep = (ph == 1) ? 2 : 1;
                for (int rep = 0; rep < nrep; ++rep) {
                    if (rep == 1) {
                        g = pg8::Gemm{WT + E_MV, MEMB, 4096, BATCH * MEMT, 1024, 1024}; S.init(g.M, g.N, G, bx); gO = VTB; gldc = 2048; }
                    pg8::EpiBf16S E{gO, gldc, gscols, gsc}; if (EN_G1) pg8::gemm_phase(L, g, S, E, tid);
                }
            }
            else if (gt == 2) { pg8::EpiSwiGLU E{BIG, FF}; if (EN_G2) pg8::gemm_phase(L, g, S, E, tid); }
            else { pg8::EpiResid E{gsrc, X, ALPHA, gres}; if (EN_G3) pg8::gemm_phase(L, g, S, E, tid); }
        } else if (ph == 0) {
            if (EN_MISC) prologue_phase(args, L, vcu, G, wave, lane);
        } else if (st == 2 || st == 7 || st == 11 || st == 14) {
            const int k = (st == 2) ? 0 : (st == 7) ? 1 : (st == 11) ? 2 : 3;
            if (EN_MISC) ln_phase(X, XB, args.ln_g + (size_t)(l * 4 + k) * DM, args.ln_b + (size_t)(l * 4 + k) * DM, gw, NGW, lane);
        } else if (st == 4) {
            if (EN_MISC && even) prep_phase(BIG, ROPE, args.ab_q_gain + jj * 64, args.ab_k_gain + jj * 64, gw, NGW, lane);
        } else if (st == 5) {
            if (even) {
                constexpr int NU = BATCH * 8 * 16; const int per = (NU + G - 1) / G; int u1 = (vcu + 1) * per; if (u1 > NU) u1 = NU;
                for (int u = vcu * per; u < u1; ++u) {
                    const int b = u >> 7, h = (u >> 4) & 7, qb = u & 15;
                    if (EN_A0) attn_body::attn_unit<0, 8>((long)b * SEQ + qb * 256, (long)b * SEQ, qb * 256, 0, 64, (const bf16*)BIG + h * 64, (const bf16*)BIG + 1024 + (h >> 2) * 64, (const bf16*)BIG + 1152 + (h >> 2) * 64, (bf16*)BIG + h * 64, 1536, (char*)lds, 0.f, tid);
                }
                constexpr int NUB = BATCH * 8 * 32; const int perb = (NUB + G - 1) / G; int ub1 = (vcu + 1) * perb; if (ub1 > NUB) ub1 = NUB;
                for (int u = vcu * perb; u < ub1; ++u) {
                    const int b = u >> 8, h = (u >> 5) & 7, qb = u & 31; const int q0 = qb * 128;
                    const float sk = args.ab_sink[jj * 8 + h] * LOG2E;
                    if (EN_A1) winattn_unit<1, 24>(L, BIG + 512 + h * 64, BIG + 1280 + (h >> 2) * 64, BIG + 1408 + (h >> 2) * 64, 1536, (long)b * SEQ, q0, q0 - 128, sk, (const LAS float*)nullptr, tid);
                }
            } else {
                constexpr int NU = BATCH * 16 * 32; const int per = (NU + G - 1) / G; int u1 = (vcu + 1) * per; if (u1 > NU) u1 = NU;
                LAS float* tab = (LAS float*)(L + 96 * 1024);
                for (int u = vcu * per; u < u1; ++u) {
                    const int b = u >> 9, h = (u >> 5) & 15, qb = u & 31; const int q0 = qb * 128, r0 = qb * 2;
                    int lo = r0 - 4; lo = lo < 0 ? 0 : lo; lo = lo > 56 ? 56 : lo;
                    if ((u == vcu * per) || qb == 0) { const float* rp = args.c_rpb + (size_t)(jj * 16 + h) * 465; __syncthreads(); for (int i = tid; i < 465; i += NWAVES * 64) tab[i] = rp[i] * LOG2E; }
                    if (EN_A2) winattn_unit<2, 36>(L, BIG + h * 64, BIG + 1024 + h * 64, BIG + 2048 + h * 64, 3072, (long)b * SEQ, q0, lo * 64, 0.f, (const LAS float*)tab, tid);
                }
            }
        } else if (st == 9) {
            if (EN_MEM) memattn_phase(L, BIG, MEMK, VTB, l, vcu, G, tid);
        }
#if MK_COOP
        if (ph + 1 < args.ph_hi) { __syncthreads(); cg::this_grid().sync(); }
#endif
    }
}

extern "C" void kernel_launch(void* const* d_in, const int* in_sizes, int n_in, void* d_out, int out_size, void* d_ws, size_t ws_size, hipStream_t stream) {
    static int grid = 0;
    if (grid == 0) {
        if (n_in != 18 || out_size != MTOK * DM || ws_size < WS_END) { fprintf(stderr, "kernel_launch: unexpected shapes (n_in %d out %d ws %zu)\n", n_in, out_size, ws_size); grid = -1; return; }
        int dev = 0, cus = 0, per_cu = 0;
        hipGetDevice(&dev); hipDeviceGetAttribute(&cus, hipDeviceAttributeMultiprocessorCount, dev);
        if (hipFuncSetAttribute((const void*)enc_fwd, hipFuncAttributeMaxDynamicSharedMemorySize, LDS_BYTES) != hipSuccess) { fprintf(stderr, "kernel_launch: hipFuncSetAttribute failed\n"); grid = -1; return; }
        if (hipOccupancyMaxActiveBlocksPerMultiprocessor(&per_cu, (const void*)enc_fwd, NWAVES * 64, LDS_BYTES) != hipSuccess || per_cu < 1) fprintf(stderr, "kernel_launch: occupancy query says %d\n", per_cu);
        (void)hipGetLastError();
        grid = cus > 0 ? cus : 256;
    }
    if (grid < 0) return;
    Args a{};
    const float** p = (const float**)&a;
    for (int i = 0; i < 18; ++i) p[i] = (const float*)d_in[i];
    a.out = (float*)d_out; a.ws = (unsigned char*)d_ws;
#if MK_COOP
    a.ph_lo = 0; a.ph_hi = N_PHASES;
    void* kargs[] = {&a};
    hipError_t e = hipLaunchCooperativeKernel((const void*)enc_fwd, dim3(grid), dim3(NWAVES * 64), kargs, LDS_BYTES, stream);
    if (e != hipSuccess) fprintf(stderr, "cooperative launch failed: %s (grid %d)\n", hipGetErrorString(e), grid);
#else
    for (int ph = 0; ph < N_PHASES; ++ph) {
        if (ph >= 2) { const int l = (ph - 2) / 15, st = (ph - 2) % 15; if (st == 4 && (l & 1)) continue; }
        a.ph_lo = ph; a.ph_hi = ph + 1;
        hipLaunchKernelGGL(enc_fwd, dim3(grid), dim3(NWAVES * 64), LDS_BYTES, stream, a);
    }
#endif
}
```
